# Optimizing an MI355X kernel written in HIP

```python
import jax, jax.numpy as jnp
from jax import lax
import numpy as np

D_MODEL = 1024
BATCH = 4
SEQ = 4096
DEPTH = 2

N_MIXERS = 2
N_ATTN_LAYERS = (DEPTH + 1) // 2
N_HGRN_LAYERS = DEPTH // 2
ATTN_HEAD_DIM = 64
ATTN_HEADS = D_MODEL // ATTN_HEAD_DIM
DILATED_PATTERNS = ((128, 1), (512, 4), (2048, 16))
N_GROUPS = len(DILATED_PATTERNS)
ROPE_THETA = 10000.0
HGRN_EXPAND = 128
HGRN_HEADS = D_MODEL // HGRN_EXPAND
HGRN_DK = HGRN_EXPAND
HGRN_DV = D_MODEL // HGRN_HEADS
HGRN_CHUNK = 64
D_FF = 4 * D_MODEL
LN_EPS = 1e-5
RMS_EPS = 1e-6
DEEPNORM_ALPHA = (2 * DEPTH) ** 0.25
DEEPNORM_BETA = (8 * DEPTH) ** -0.25

kernel_name = 'hybrid_dilated_attn_hgrn2_deepnorm'

F32 = jnp.float32


def layer_norm(x, g, b):
    xf = x.astype(F32)
    mu = jnp.mean(xf, axis=-1, keepdims=True)
    var = jnp.mean(jnp.square(xf - mu), axis=-1, keepdims=True)
    return ((xf - mu) * lax.rsqrt(var + LN_EPS) * g.astype(F32) + b.astype(F32)).astype(x.dtype)


def rotary(x, pos):
    e = x.shape[-1]
    half = e // 2
    inv = ROPE_THETA ** (-jnp.arange(half, dtype=F32) * (2.0 / e))
    ang = pos.astype(F32)[:, None] * inv[None, :]
    cos = jnp.cos(ang)[None, :, None, :]
    sin = jnp.sin(ang)[None, :, None, :]
    xf = x.astype(F32)
    x1, x2 = xf[..., :half], xf[..., half:]
    return jnp.concatenate([x1 * cos - x2 * sin, x2 * cos + x1 * sin], axis=-1).astype(x.dtype)


def dilated_window_attention(q, k, v, window, dilation):
    B, S, H, E = q.shape
    blk = window // dilation
    span = dilation * blk
    s_pad = -(-S // span) * span
    n = s_pad // dilation
    nb = n // blk
    pad = ((0, 0), (0, s_pad - S), (0, 0), (0, 0))

    def to_blocks(t):
        t = jnp.pad(t, pad).reshape(B, n, dilation, H, E).transpose(0, 2, 1, 3, 4)
        return t.reshape(B * dilation, nb, blk, H, E)

    def with_prev(t):
        prev = jnp.pad(t, ((0, 0), (1, 0), (0, 0), (0, 0), (0, 0)))[:, :-1]
        return jnp.concatenate([prev, t], axis=2)

    qb, kb, vb = to_blocks(q), to_blocks(k), to_blocks(v)
    kk, vv = with_prev(kb), with_prev(vb)
    s = jnp.einsum('znqhe,znkhe->znhqk', qb, kk).astype(F32) * (E ** -0.5)
    qi = jnp.arange(blk)[:, None]
    kj = jnp.arange(2 * blk)[None, :]
    dist = qi + blk - kj
    in_band = (dist >= 0) & (dist <= blk)
    kabs = jnp.arange(nb)[:, None, None] * blk + kj[None] - blk
    valid = in_band[None] & (kabs >= 0)
    s = jnp.where(valid[None, :, None], s, -jnp.inf)
    m = jnp.max(s, axis=-1, keepdims=True)
    p = jnp.exp(s - m)
    l = jnp.sum(p, axis=-1, keepdims=True)
    o = jnp.einsum('znhqk,znkhe->znqhe', (p / l).astype(v.dtype), vv)
    lse = (m + jnp.log(l))[..., 0].transpose(0, 1, 3, 2)

    def from_blocks(t):
        t = t.reshape(B, dilation, n, *t.shape[3:]).swapaxes(1, 2)
        return t.reshape(B, s_pad, *t.shape[3:])[:, :S]

    return from_blocks(o), from_blocks(lse)


def dilated_attention_mixer(x, w_in, w_out):
    B, S, _ = x.shape
    proj = (x @ w_in).reshape(B, S, N_GROUPS, 3, ATTN_HEADS, ATTN_HEAD_DIM)
    pos = jnp.arange(S)
    outs, lses = [], []
    for g, (window, dilation) in enumerate(DILATED_PATTERNS):
        q = rotary(proj[:, :, g, 0], pos)
        k = rotary(proj[:, :, g, 1], pos)
        o, lse = dilated_window_attention(q, k, proj[:, :, g, 2], window, dilation)
        outs.append(o)
        lses.append(lse)
    wts = jax.nn.softmax(jnp.stack(lses, axis=0), axis=0)
    o = jnp.einsum('gbsh,gbshe->bshe', wts, jnp.stack(outs, axis=0).astype(F32))
    return o.reshape(B, S, ATTN_HEADS * ATTN_HEAD_DIM).astype(x.dtype) @ w_out


def forget_lower_bounds(lb_logits):
    c = jnp.cumsum(jax.nn.softmax(lb_logits.astype(F32), axis=0), axis=0)
    return c - c[0]


def hgrn2_mixer(x, w_in, w_out, norm_g, lb):
    B, S, _ = x.shape
    H, K, V, C = HGRN_HEADS, HGRN_DK, HGRN_DV, HGRN_CHUNK
    nc = S // C
    q_raw, f_raw, i_raw = jnp.split(x @ w_in, [H * K, 2 * H * K], axis=-1)
    z = f_raw.astype(F32)
    log_f = jnp.logaddexp(jnp.log(lb), jnp.log1p(-lb) + jax.nn.log_sigmoid(z))
    key = (1.0 - lb) * jax.nn.sigmoid(-z)
    q = jax.nn.silu(q_raw.astype(F32))
    v = i_raw.astype(F32)

    def chunks(t, d):
        return t.reshape(B, nc, C, H, d).transpose(0, 3, 1, 2, 4)

    q, key, log_f, v = chunks(q, K), chunks(key, K), chunks(log_f, K), chunks(v, V)
    b = jnp.cumsum(log_f, axis=3)
    q_dec = q * jnp.exp(b)
    k_dec = key * jnp.exp(-b)
    causal = jnp.tril(jnp.ones((C, C), dtype=bool))
    a = jnp.where(causal, jnp.einsum('bhcid,bhcjd->bhcij', q_dec, k_dec), 0.0)
    o_intra = jnp.einsum('bhcij,bhcje->bhcie', a, v)
    b_last = b[:, :, :, -1:, :]
    kv = jnp.einsum('bhcjd,bhcje->bhcde', key * jnp.exp(b_last - b), v)
    chunk_decay = jnp.exp(b_last[:, :, :, 0, :])

    def step(state, inp):
        dec, kv_c = inp
        return dec[..., None] * state + kv_c, state

    s0 = jnp.zeros((B, H, K, V), F32)
    _, states = lax.scan(step, s0, (jnp.moveaxis(chunk_decay, 2, 0), jnp.moveaxis(kv, 2, 0)))
    o_inter = jnp.einsum('bhcid,cbhde->bhcie', q_dec, states)
    o = (o_intra + o_inter).transpose(0, 2, 3, 1, 4).reshape(B, S, H, V)
    o = o * lax.rsqrt(jnp.mean(o * o, axis=-1, keepdims=True) + RMS_EPS) * norm_g.astype(F32).reshape(H, V)
    return o.reshape(B, S, H * V).astype(x.dtype) @ w_out


def squared_relu_mlp(x, w_up, w_down):
    return jnp.square(jax.nn.relu(x @ w_up)) @ w_down


def setup_inputs(seed: int = 0) -> dict:
    key = jax.random.key(seed)
    ks = jax.random.split(key, 13)
    d_attn_in = N_GROUPS * 3 * ATTN_HEADS * ATTN_HEAD_DIM
    d_attn_out = ATTN_HEADS * ATTN_HEAD_DIM
    d_hgrn_in = 2 * HGRN_HEADS * HGRN_DK + HGRN_HEADS * HGRN_DV
    d_hgrn_out = HGRN_HEADS * HGRN_DV
    nrm = lambda k, shape, scale: jax.random.normal(k, shape, F32) * scale
    return {
        'x': nrm(ks[0], (BATCH, SEQ, D_MODEL), 1.0),
        'attn_w_in': nrm(ks[1], (N_ATTN_LAYERS, D_MODEL, d_attn_in), D_MODEL ** -0.5),
        'attn_w_out': nrm(ks[2], (N_ATTN_LAYERS, d_attn_out, D_MODEL), d_attn_out ** -0.5 * DEEPNORM_BETA),
        'hgrn_w_in': nrm(ks[3], (N_HGRN_LAYERS, D_MODEL, d_hgrn_in), D_MODEL ** -0.5),
        'hgrn_w_out': nrm(ks[4], (N_HGRN_LAYERS, d_hgrn_out, D_MODEL), d_hgrn_out ** -0.5 * DEEPNORM_BETA),
        'hgrn_norm_g': 1.0 + nrm(ks[5], (N_HGRN_LAYERS, d_hgrn_out), 0.02),
        'lb_logits': nrm(ks[6], (DEPTH, HGRN_HEADS * HGRN_DK), 0.1),
        'ln_mix_g': 1.0 + nrm(ks[7], (DEPTH, D_MODEL), 0.02),
        'ln_mix_b': nrm(ks[8], (DEPTH, D_MODEL), 0.02),
        'ln_ffn_g': 1.0 + nrm(ks[9], (DEPTH, D_MODEL), 0.02),
        'ln_ffn_b': nrm(ks[10], (DEPTH, D_MODEL), 0.02),
        'ffn_w_up': nrm(ks[11], (DEPTH, D_MODEL, D_FF), D_MODEL ** -0.5),
        'ffn_w_down': nrm(ks[12], (DEPTH, D_FF, D_MODEL), D_FF ** -0.5 * DEEPNORM_BETA),
    }


def reference(x, attn_w_in, attn_w_out, hgrn_w_in, hgrn_w_out, hgrn_norm_g, lb_logits,
              ln_mix_g, ln_mix_b, ln_ffn_g, ln_ffn_b, ffn_w_up, ffn_w_down):
    lbs = forget_lower_bounds(lb_logits)
    for i in range(DEPTH):
        j = i // N_MIXERS
        if i % N_MIXERS == 0:
            y = dilated_attention_mixer(x, attn_w_in[j], attn_w_out[j])
        else:
            y = hgrn2_mixer(x, hgrn_w_in[j], hgrn_w_out[j], hgrn_norm_g[j], lbs[i])
        x = layer_norm(DEEPNORM_ALPHA * x + y, ln_mix_g[i], ln_mix_b[i])
        y = squared_relu_mlp(x, ffn_w_up[i], ffn_w_down[i])
        x = layer_norm(DEEPNORM_ALPHA * x + y, ln_ffn_g[i], ln_ffn_b[i])
    return x
```

```cpp
#include <hip/hip_runtime.h>
#include <cstdio>
#include <cstdint>

namespace nv {
constexpr int DM = 1024, BATCH = 4, SEQ = 4096, M = BATCH * SEQ, FF = 4096;
constexpr float ALPHA = 1.41421356237309515f;
constexpr float LN_EPS = 1e-5f, RMS_EPS = 1e-6f;

template <int ACT>
__global__ void __launch_bounds__(256) gemm_f32(const float* __restrict__ A, int lda, const float* __restrict__ W, int ldw, float* __restrict__ C, int ldc, int Mr, int N, int K) {
    __shared__ float As[16][64 + 4];
    __shared__ float Ws[16][64 + 4];
    const int tid = threadIdx.x, tx = tid & 15, ty = tid >> 4;
    const int m0 = blockIdx.y * 64, n0 = blockIdx.x * 64;
    float acc[4][4];
#pragma unroll
    for (int i = 0; i < 4; ++i)
#pragma unroll
        for (int j = 0; j < 4; ++j) acc[i][j] = 0.f;
    for (int k0 = 0; k0 < K; k0 += 16) {
        {
            const int r = tid >> 2, kk = (tid & 3) * 4;
            const float4 v = *(const float4*)(A + (size_t)(m0 + r) * lda + k0 + kk);
            As[kk + 0][r] = v.x; As[kk + 1][r] = v.y; As[kk + 2][r] = v.z; As[kk + 3][r] = v.w;
        }
        {
            const int kk = tid >> 4, c = (tid & 15) * 4;
            const float4 v = *(const float4*)(W + (size_t)(k0 + kk) * ldw + n0 + c);
            Ws[kk][c + 0] = v.x; Ws[kk][c + 1] = v.y; Ws[kk][c + 2] = v.z; Ws[kk][c + 3] = v.w;
        }
        __syncthreads();
#pragma unroll
        for (int kk = 0; kk < 16; ++kk) {
            float a[4], b[4];
#pragma unroll
            for (int i = 0; i < 4; ++i) a[i] = As[kk][ty * 4 + i];
#pragma unroll
            for (int j = 0; j < 4; ++j) b[j] = Ws[kk][tx * 4 + j];
#pragma unroll
            for (int i = 0; i < 4; ++i)
#pragma unroll
                for (int j = 0; j < 4; ++j) acc[i][j] = fmaf(a[i], b[j], acc[i][j]);
        }
        __syncthreads();
    }
#pragma unroll
    for (int i = 0; i < 4; ++i) {
        float4 o;
        float v[4];
#pragma unroll
        for (int j = 0; j < 4; ++j) { float x = acc[i][j]; if (ACT == 1) { x = x > 0.f ? x : 0.f; x = x * x; } v[j] = x; }
        o.x = v[0]; o.y = v[1]; o.z = v[2]; o.w = v[3];
        *(float4*)(C + (size_t)(m0 + ty * 4 + i) * ldc + n0 + tx * 4) = o;
    }
}

__global__ void __launch_bounds__(256) rot_kernel(float* __restrict__ P) {
    const size_t idx = (size_t)blockIdx.x * 256 + threadIdx.x;
    const int e = idx & 31; size_t r = idx >> 5;
    const int h = r & 15; r >>= 4;
    const int t = r & 1; r >>= 1;
    const int g = r % 3; const int pos = (int)(r / 3);
    const float inv = powf(10000.0f, -(float)e * (2.0f / 64.0f));
    const float ang = (float)pos * inv;
    const float c = cosf(ang), s = sinf(ang);
    float* p = P + (size_t)pos * 9216 + g * 3072 + t * 1024 + h * 64 + e;
    const float x1 = p[0], x2 = p[32];
    p[0] = x1 * c - x2 * s; p[32] = x2 * c + x1 * s;
}

__device__ __forceinline__ float wsum(float v) {
#pragma unroll
    for (int o = 32; o > 0; o >>= 1) v += __shfl_xor(v, o);
    return v;
}
__global__ void __launch_bounds__(256) attn_naive(const float* __restrict__ P, float* __restrict__ O  ) {
    const int wave = (blockIdx.x * 256 + threadIdx.x) >> 6, lane = threadIdx.x & 63;
    const int h = wave & 15, pos = wave >> 4;
    float og[3], lse[3];
#pragma unroll
    for (int g = 0; g < 3; ++g) {
        const int dl = (g == 0) ? 1 : (g == 1) ? 4 : 16;
        const float q = P[(size_t)pos * 9216 + g * 3072 + h * 64 + lane];
        float m = -INFINITY, l = 0.f, acc = 0.f;
        for (int mm = 0; mm <= 128; ++mm) {
            const int kp = pos - mm * dl; if (kp < 0) break;
            const float k = P[(size_t)kp * 9216 + g * 3072 + 1024 + h * 64 + lane];
            const float v = P[(size_t)kp * 9216 + g * 3072 + 2048 + h * 64 + lane];
            const float s = wsum(q * k) * 0.125f;
            const float mn = fmaxf(m, s);
            const float f = expf(m - mn), p = expf(s - mn);
            l = l * f + p; acc = acc * f + p * v; m = mn;
        }
        og[g] = acc / l; lse[g] = m + logf(l);
    }
    const float mx = fmaxf(lse[0], fmaxf(lse[1], lse[2]));
    const float w0 = expf(lse[0] - mx), w1 = expf(lse[1] - mx), w2 = expf(lse[2] - mx);
    O[(size_t)pos * 1024 + h * 64 + lane] = (w0 * og[0] + w1 * og[1] + w2 * og[2]) / (w0 + w1 + w2);
}

__global__ void __launch_bounds__(256) ln_res(const float* xin, const float* __restrict__ y, const float* __restrict__ g, const float* __restrict__ b, float* out) {
    __shared__ float red[8];
    const int row = blockIdx.x, tid = threadIdx.x;
    const float4 xv = *(const float4*)(xin + (size_t)row * DM + tid * 4), yv = *(const float4*)(y + (size_t)row * DM + tid * 4);
    float v[4] = {ALPHA * xv.x + yv.x, ALPHA * xv.y + yv.y, ALPHA * xv.z + yv.z, ALPHA * xv.w + yv.w};
    float s = wsum(v[0] + v[1] + v[2] + v[3]);
    if ((tid & 63) == 0) red[tid >> 6] = s;
    __syncthreads();
    const float mean = (red[0] + red[1] + red[2] + red[3]) * (1.f / DM);
    float q = 0.f;
#pragma unroll
    for (int i = 0; i < 4; ++i) { v[i] -= mean; q += v[i] * v[i]; }
    q = wsum(q);
    if ((tid & 63) == 0) red[4 + (tid >> 6)] = q;
    __syncthreads();
    const float rstd = 1.0f / sqrtf((red[4] + red[5] + red[6] + red[7]) * (1.f / DM) + LN_EPS);
    const float4 gv = *(const float4*)(g + tid * 4), bv = *(const float4*)(b + tid * 4);
    float4 o; o.x = v[0] * rstd * gv.x + bv.x; o.y = v[1] * rstd * gv.y + bv.y; o.z = v[2] * rstd * gv.z + bv.z; o.w = v[3] * rstd * gv.w + bv.w;
    *(float4*)(out + (size_t)row * DM + tid * 4) = o;
}

__global__ void __launch_bounds__(256) hgrn_naive(const float* __restrict__ P  , const float* __restrict__ lb_logits  , const float* __restrict__ norm_g  , float* __restrict__ O  ) {
    extern __shared__ float sm[];
    float* S = sm;
    float* qs = sm + 128 * 128;
    float* fs = qs + 128;
    float* ks = fs + 128;
    float* vs = ks + 128;
    float* part = vs + 128;
    float* red = part + 256;
    const int h = blockIdx.x & 7, tid = threadIdx.x, e = tid & 127, half = tid >> 7;
    P += (size_t)(blockIdx.x >> 3) * 4096 * 3072; O += (size_t)(blockIdx.x >> 3) * 4096 * 1024;
    for (int i = tid; i < 128 * 128; i += 256) S[i] = 0.f;
    float lb = 0.f;
    if (tid < 128) { const float l0 = lb_logits[h * 128 + tid], l1 = lb_logits[1024 + h * 128 + tid]; const float mx = fmaxf(l0, l1); const float e0 = expf(l0 - mx), e1 = expf(l1 - mx); lb = e1 / (e0 + e1); }
    const float ng = norm_g[h * 128 + e];
    __syncthreads();
    for (int t = 0; t < 4096; ++t) {
        if (tid < 128) {
            const float qr = P[(size_t)t * 3072 + h * 128 + tid], z = P[(size_t)t * 3072 + 1024 + h * 128 + tid];
            qs[tid] = qr / (1.f + expf(-qr));
            const float sg = 1.f / (1.f + expf(-z));
            fs[tid] = lb + (1.f - lb) * sg;
            ks[tid] = (1.f - lb) * (1.f - sg);
        } else {
            vs[tid - 128] = P[(size_t)t * 3072 + 2048 + h * 128 + (tid - 128)];
        }
        __syncthreads();
        const float v = vs[e];
        float o = 0.f;
        for (int d = half * 64; d < half * 64 + 64; ++d) {
            const float s = fs[d] * S[d * 128 + e] + ks[d] * v;
            S[d * 128 + e] = s;
            o = fmaf(qs[d], s, o);
        }
        part[tid] = o;
        __syncthreads();
        float ot = 0.f, sq = 0.f;
        if (tid < 128) { ot = part[tid] + part[tid + 128]; sq = ot * ot; }
        sq = wsum(sq);
        if ((tid & 63) == 0) red[tid >> 6] = sq;
        __syncthreads();
        if (tid < 128) {
            const float ms = (red[0] + red[1]) * (1.f / 128.f);
            O[(size_t)t * 1024 + h * 128 + tid] = ot * (1.0f / sqrtf(ms + RMS_EPS)) * ng;
        }
        __syncthreads();
    }
}
}

extern "C" void kernel_launch(void* const* d_in, const int* in_sizes, int n_in, void* d_out, int out_size, void* d_ws, size_t ws_size, hipStream_t stream) {
    using namespace nv;
    const float* x = (const float*)d_in[0];
    const float* attn_w_in = (const float*)d_in[1];
    const float* attn_w_out = (const float*)d_in[2];
    const float* hgrn_w_in = (const float*)d_in[3];
    const float* hgrn_w_out = (const float*)d_in[4];
    const float* hgrn_norm_g = (const float*)d_in[5];
    const float* lb_logits = (const float*)d_in[6];
    const float* ln_mix_g = (const float*)d_in[7];
    const float* ln_mix_b = (const float*)d_in[8];
    const float* ln_ffn_g = (const float*)d_in[9];
    const float* ln_ffn_b = (const float*)d_in[10];
    const float* ffn_w_up = (const float*)d_in[11];
    const float* ffn_w_down = (const float*)d_in[12];
    float* out = (float*)d_out;
    constexpr size_t MiB = 1u << 20;
    float* PROJ = (float*)((char*)d_ws);
    float* OMIX = (float*)((char*)d_ws + 144 * MiB);
    float* Y = (float*)((char*)d_ws + 64 * MiB);
    static bool attr = false;
    if (!attr) { (void)hipFuncSetAttribute((const void*)hgrn_naive, hipFuncAttributeMaxDynamicSharedMemorySize, 70000); attr = true; }

    for (int b = 0; b < BATCH; ++b) {
        gemm_f32<0><<<dim3(9216 / 64, SEQ / 64), 256, 0, stream>>>(x + (size_t)b * SEQ * DM, DM, attn_w_in, 9216, PROJ, 9216, SEQ, 9216, DM);
        rot_kernel<<<(4096 * 3 * 2 * 16 * 32) / 256, 256, 0, stream>>>(PROJ);
        attn_naive<<<(SEQ * 16 * 64) / 256, 256, 0, stream>>>(PROJ, OMIX + (size_t)b * SEQ * DM);
    }
    gemm_f32<0><<<dim3(DM / 64, M / 64), 256, 0, stream>>>(OMIX, DM, attn_w_out, DM, Y, DM, M, DM, DM);
    ln_res<<<M, 256, 0, stream>>>(x, Y, ln_mix_g, ln_mix_b, out);
    for (int l = 0; l < 2; ++l) {
        if (l == 1) {
            float* OMIX2 = (float*)((char*)d_ws + 192 * MiB);
            gemm_f32<0><<<dim3(3072 / 64, M / 64), 256, 0, stream>>>(out, DM, hgrn_w_in, 3072, PROJ, 3072, M, 3072, DM);
            hgrn_naive<<<32, 256, 70000, stream>>>(PROJ, lb_logits, hgrn_norm_g, OMIX2);
            gemm_f32<0><<<dim3(DM / 64, M / 64), 256, 0, stream>>>(OMIX2, DM, hgrn_w_out, DM, Y, DM, M, DM, DM);
            ln_res<<<M, 256, 0, stream>>>(out, Y, ln_mix_g + DM, ln_mix_b + DM, out);
        }
        for (int b = 0; b < BATCH; ++b) {
            gemm_f32<1><<<dim3(FF / 64, SEQ / 64), 256, 0, stream>>>(out + (size_t)b * SEQ * DM, DM, ffn_w_up + (size_t)l * DM * FF, FF, PROJ, FF, SEQ, FF, DM);
            gemm_f32<0><<<dim3(DM / 64, SEQ / 64), 256, 0, stream>>>(PROJ, FF, ffn_w_down + (size_t)l * FF * DM, DM, Y + (size_t)b * SEQ * DM, DM, SEQ, DM, FF);
        }
        ln_res<<<M, 256, 0, stream>>>(out, Y, ln_ffn_g + (size_t)l * DM, ln_ffn_b + (size_t)l * DM, out);
    }
}
```
